# Optimizing an MI355X kernel written in HIP

```python
import math
import jax, jax.numpy as jnp
from jax import lax
import numpy as np

D_MODEL = 1024
BATCH = 8
SEQ = 4096
DEPTH = 1

POOL_WINDOWS = (2, 4, 8, 16)
N_POOL_GROUPS = len(POOL_WINDOWS)
POOL_WIDTH = D_MODEL // 2
POOL_GROUP = POOL_WIDTH // N_POOL_GROUPS

MLA_HEADS = 8
QK_NOPE = 64
QK_ROPE = 32
QK_DIM = QK_NOPE + QK_ROPE
V_HEAD = 64
MLA_WIDTH = MLA_HEADS * V_HEAD
Q_LORA = 256
KV_LORA = 128
ROPE_THETA = 10000.0
Q_BLOCK = 128

IN_WIDTH = POOL_WIDTH + Q_LORA + KV_LORA + QK_ROPE
MIX_WIDTH = POOL_WIDTH + MLA_WIDTH

N_EXPERTS = 64
TOP_K = 8
N_GROUPS = 8
TOPK_GROUPS = 4
D_EXPERT = 256
D_SHARED = 256
ROUTED_SCALE = 2.5
MOE_BLOCK = 128

ALPHA = (2 * DEPTH) ** 0.25
BETA = (8 * DEPTH) ** -0.25
LN_EPS = 1e-5
RMS_EPS = 1e-6

kernel_name = "hybrid_pool_mla_moe_deepnorm"


def layer_norm(x, g, b):
    xf = x.astype(jnp.float32)
    mu = jnp.mean(xf, axis=-1, keepdims=True)
    xc = xf - mu
    var = jnp.mean(xc * xc, axis=-1, keepdims=True)
    return (xc * lax.rsqrt(var + LN_EPS) * g + b).astype(x.dtype)


def rms_norm(x, g):
    xf = x.astype(jnp.float32)
    ms = jnp.mean(xf * xf, axis=-1, keepdims=True)
    return (xf * lax.rsqrt(ms + RMS_EPS) * g).astype(x.dtype)


def window_mean(u, w):
    B, S, C = u.shape
    left = w // 2
    right = w - 1 - left
    c = jnp.concatenate([jnp.zeros((B, 1, C), jnp.float32),
                         jnp.cumsum(u.astype(jnp.float32), axis=1)], axis=1)
    pos = jnp.arange(S)
    lo = jnp.clip(pos - left, 0, S)
    hi = jnp.clip(pos + right + 1, 0, S)
    count = (hi - lo).astype(jnp.float32)
    mean = (c[:, hi] - c[:, lo]) / count[None, :, None]
    return mean.astype(u.dtype)


def pool_mixer(u, w_pool, pool_scale):
    B, S, _ = u.shape
    ug = u.reshape(B, S, N_POOL_GROUPS, POOL_GROUP)
    pooled = jnp.stack([window_mean(ug[:, :, g], w) for g, w in enumerate(POOL_WINDOWS)], axis=2) - ug
    y = jnp.einsum('bsgc,gcd->bsgd', pooled, w_pool)
    return y.reshape(B, S, POOL_WIDTH) * pool_scale


def apply_rope(t, cos, sin):
    t1, t2 = jnp.split(t, 2, axis=-1)
    return jnp.concatenate([t1 * cos - t2 * sin, t2 * cos + t1 * sin], axis=-1)


def mla(q_lat, kv_lat, k_rope_in, q_norm_g, w_q_up, kv_norm_g, w_kv_up):
    B, S, _ = q_lat.shape
    q = (rms_norm(q_lat, q_norm_g) @ w_q_up).reshape(B, S, MLA_HEADS, QK_DIM)
    kv = (rms_norm(kv_lat, kv_norm_g) @ w_kv_up).reshape(B, S, MLA_HEADS, QK_NOPE + V_HEAD)
    k_nope, v = kv[..., :QK_NOPE], kv[..., QK_NOPE:]

    pos = jnp.arange(S, dtype=jnp.float32)
    inv_freq = ROPE_THETA ** (-jnp.arange(0, QK_ROPE, 2, dtype=jnp.float32) / QK_ROPE)
    ang = pos[:, None] * inv_freq[None, :]
    cos = jnp.cos(ang)[:, None, :].astype(q.dtype)
    sin = jnp.sin(ang)[:, None, :].astype(q.dtype)

    q = jnp.concatenate([q[..., :QK_NOPE], apply_rope(q[..., QK_NOPE:], cos, sin)], axis=-1)
    k_rope = apply_rope(k_rope_in[:, :, None, :], cos, sin)
    k = jnp.concatenate([k_nope, jnp.broadcast_to(k_rope, (B, S, MLA_HEADS, QK_ROPE))], axis=-1)

    scale = QK_DIM ** -0.5
    n_blk = S // Q_BLOCK
    q_blocks = q.reshape(B, n_blk, Q_BLOCK, MLA_HEADS, QK_DIM).transpose(1, 0, 2, 3, 4)

    def attend(qb):
        s = jnp.einsum('bqhd,bkhd->bhqk', qb, k, preferred_element_type=jnp.float32) * scale
        p = jax.nn.softmax(s, axis=-1).astype(v.dtype)
        return jnp.einsum('bhqk,bkhd->bqhd', p, v)

    o = lax.map(attend, q_blocks)
    return o.transpose(1, 0, 2, 3, 4).reshape(B, S, MLA_WIDTH)


def moe(h, w_router, router_bias, w_gate, w_up, w_down, w_sh_gate, w_sh_up, w_sh_down):
    B, S, D = h.shape
    xf = h.reshape(-1, D)
    N = xf.shape[0]
    NK = N * TOP_K

    logits = jnp.einsum('nd,de->ne', xf, w_router, preferred_element_type=jnp.float32)
    scores = jax.nn.sigmoid(logits)
    biased = scores + router_bias.astype(jnp.float32)
    grp_score = lax.top_k(biased.reshape(N, N_GROUPS, N_EXPERTS // N_GROUPS), 2)[0].sum(-1)
    _, top_grp = lax.top_k(grp_score, TOPK_GROUPS)
    grp_mask = jnp.any(top_grp[..., None] == jnp.arange(N_GROUPS), axis=1)
    expert_mask = jnp.repeat(grp_mask, N_EXPERTS // N_GROUPS, axis=1)
    _, top_idx = lax.top_k(jnp.where(expert_mask, biased, -jnp.inf), TOP_K)
    top_w = jnp.take_along_axis(scores, top_idx, axis=1)
    top_w = top_w / jnp.sum(top_w, axis=-1, keepdims=True) * ROUTED_SCALE

    flat_e = top_idx.reshape(-1)
    order = jnp.argsort(flat_e)
    sorted_e = flat_e[order]
    tok = order // TOP_K
    sizes = jnp.bincount(flat_e, length=N_EXPERTS)
    padded = (sizes + MOE_BLOCK - 1) // MOE_BLOCK * MOE_BLOCK
    pad_end = jnp.cumsum(padded)
    pad_start = pad_end - padded
    start = jnp.cumsum(sizes) - sizes
    dest = pad_start[sorted_e] + jnp.arange(NK) - start[sorted_e]
    n_blocks = -(-(NK + N_EXPERTS * (MOE_BLOCK - 1)) // MOE_BLOCK)
    P = n_blocks * MOE_BLOCK

    slot_tok = jnp.full((P,), N, jnp.int32).at[dest].set(tok.astype(jnp.int32))
    slot_w = jnp.zeros((P,), jnp.float32).at[dest].set(top_w.reshape(-1)[order])
    x_pad = jnp.concatenate([xf, jnp.zeros((1, D), xf.dtype)], axis=0)
    buf = x_pad[slot_tok].reshape(n_blocks, MOE_BLOCK, D)
    block_e = jnp.minimum(jnp.searchsorted(pad_end, jnp.arange(n_blocks) * MOE_BLOCK, side='right'),
                          N_EXPERTS - 1)

    def expert_block(args):
        xb, e = args
        return (jax.nn.silu(xb @ w_gate[e]) * (xb @ w_up[e])) @ w_down[e]

    out_buf = lax.map(expert_block, (buf, block_e)).reshape(P, D)
    routed = jnp.zeros((N + 1, D), xf.dtype).at[slot_tok].add(
        out_buf * slot_w[:, None].astype(xf.dtype))[:N]
    shared = (jax.nn.silu(xf @ w_sh_gate) * (xf @ w_sh_up)) @ w_sh_down
    return (routed + shared).reshape(B, S, D)


def setup_inputs(seed: int = 0) -> dict:
    key = jax.random.key(seed)
    ks = jax.random.split(key, 24)
    L = DEPTH

    def nrm(k, shape, scale):
        return jax.random.normal(k, shape, jnp.float32) * scale

    v_scale = jnp.concatenate([jnp.ones((QK_NOPE,), jnp.float32), jnp.full((V_HEAD,), BETA, jnp.float32)])
    w_kv_up = (nrm(ks[6], (L, KV_LORA, MLA_HEADS, QK_NOPE + V_HEAD), KV_LORA ** -0.5) * v_scale
               ).reshape(L, KV_LORA, MLA_HEADS * (QK_NOPE + V_HEAD))
    return {
        "x": nrm(ks[0], (BATCH, SEQ, D_MODEL), 1.0),
        "w_in": nrm(ks[1], (L, D_MODEL, IN_WIDTH), D_MODEL ** -0.5),
        "w_pool": nrm(ks[2], (L, N_POOL_GROUPS, POOL_GROUP, POOL_GROUP), POOL_GROUP ** -0.5),
        "pool_scale": 1.0 + nrm(ks[3], (L, POOL_WIDTH), 0.1),
        "q_norm_g": 1.0 + nrm(ks[4], (L, Q_LORA), 0.02),
        "w_q_up": nrm(ks[5], (L, Q_LORA, MLA_HEADS * QK_DIM), Q_LORA ** -0.5),
        "kv_norm_g": 1.0 + nrm(ks[7], (L, KV_LORA), 0.02),
        "w_kv_up": w_kv_up,
        "w_out": nrm(ks[8], (L, MIX_WIDTH, D_MODEL), MIX_WIDTH ** -0.5 * BETA),
        "ln1_g": 1.0 + nrm(ks[9], (L, D_MODEL), 0.02),
        "ln1_b": nrm(ks[10], (L, D_MODEL), 0.02),
        "w_router": nrm(ks[11], (L, D_MODEL, N_EXPERTS), D_MODEL ** -0.5),
        "router_bias": nrm(ks[12], (L, N_EXPERTS), 0.01),
        "w_gate": nrm(ks[13], (L, N_EXPERTS, D_MODEL, D_EXPERT), D_MODEL ** -0.5),
        "w_up": nrm(ks[14], (L, N_EXPERTS, D_MODEL, D_EXPERT), D_MODEL ** -0.5),
        "w_down": nrm(ks[15], (L, N_EXPERTS, D_EXPERT, D_MODEL), D_EXPERT ** -0.5 * BETA),
        "w_sh_gate": nrm(ks[16], (L, D_MODEL, D_SHARED), D_MODEL ** -0.5),
        "w_sh_up": nrm(ks[17], (L, D_MODEL, D_SHARED), D_MODEL ** -0.5),
        "w_sh_down": nrm(ks[18], (L, D_SHARED, D_MODEL), D_SHARED ** -0.5 * BETA),
        "ln2_g": 1.0 + nrm(ks[19], (L, D_MODEL), 0.02),
        "ln2_b": nrm(ks[20], (L, D_MODEL), 0.02),
    }


def reference(x, w_in, w_pool, pool_scale, q_norm_g, w_q_up, kv_norm_g, w_kv_up, w_out,
              ln1_g, ln1_b, w_router, router_bias, w_gate, w_up, w_down,
              w_sh_gate, w_sh_up, w_sh_down, ln2_g, ln2_b):
    h = x
    splits = [POOL_WIDTH, POOL_WIDTH + Q_LORA, POOL_WIDTH + Q_LORA + KV_LORA]
    for l in range(DEPTH):
        proj = h @ w_in[l]
        u_pool, q_lat, kv_lat, k_rope = jnp.split(proj, splits, axis=-1)
        y_pool = pool_mixer(u_pool, w_pool[l], pool_scale[l])
        y_mla = mla(q_lat, kv_lat, k_rope, q_norm_g[l], w_q_up[l], kv_norm_g[l], w_kv_up[l])
        mixed = jnp.concatenate([y_pool, y_mla], axis=-1) @ w_out[l]
        h = layer_norm(ALPHA * h + mixed, ln1_g[l], ln1_b[l])
        f = moe(h, w_router[l], router_bias[l], w_gate[l], w_up[l], w_down[l],
                w_sh_gate[l], w_sh_up[l], w_sh_down[l])
        h = layer_norm(ALPHA * h + f, ln2_g[l], ln2_b[l])
    return h
```

```cpp
#include <hip/hip_runtime.h>
#include <cstdio>
#include <cstdint>

#define DEVI __device__ __forceinline__
#define GAS __attribute__((address_space(1)))
#define LAS __attribute__((address_space(3)))
typedef unsigned short bf16;
typedef short bf16x8 __attribute__((ext_vector_type(8)));
typedef float f32x4 __attribute__((ext_vector_type(4)));
typedef float f32x16 __attribute__((ext_vector_type(16)));
typedef unsigned u32x4 __attribute__((ext_vector_type(4)));
typedef unsigned u32x2 __attribute__((ext_vector_type(2)));
typedef GAS unsigned gu32;
#define RLX_AGENT __ATOMIC_RELAXED, __HIP_MEMORY_SCOPE_AGENT

constexpr int NTOK = 32768, DM = 1024, SEQ = 4096, NBATCH = 8, NHEAD = 8;
constexpr int QKD = 96, VD = 64, QLORA = 256, KVLORA = 128, NEXP = 64, DEXP = 256;
constexpr int HALF_T = 16384;
constexpr int NSLOT_H = HALF_T * 8 + HALF_T;
constexpr float ALPHA = 1.189207115002721f;
constexpr float LN_EPS = 1e-5f, RMS_EPS = 1e-6f;
constexpr float C2 = 0.10206207261596577f * 1.4426950408889634f;

constexpr size_t MiB = 1u << 20;
constexpr size_t WS_CTL = 0, CTL_ZERO_BYTES = 1 * MiB;
constexpr size_t WS_H1B = 1 * MiB;
constexpr size_t WS_W13T = 65 * MiB;
constexpr size_t WS_TOKSLOT = 130 * MiB;
constexpr size_t WS_TOKW = 131 * MiB;
constexpr size_t WS_LIST = 132 * MiB;
constexpr size_t WS_SSQ = 140 * MiB;
constexpr size_t WS_ROPE = 140 * MiB + 512 * 1024;
constexpr size_t WS_WIN = 141 * MiB;
constexpr size_t WS_WQ = 143 * MiB;
constexpr size_t WS_WKV = 143 * MiB + 512 * 1024;
constexpr size_t WS_WO = 144 * MiB;
constexpr size_t WS_R = 149 * MiB;
constexpr size_t WS_SLOT = WS_R;
constexpr size_t WS_ACT = WS_R + 288 * MiB;
constexpr size_t WS_XB = WS_R;
constexpr size_t WS_PROJ = WS_R + 64 * MiB;
constexpr size_t WS_Q = WS_R + 128 * MiB;
constexpr size_t WS_K = WS_R + 176 * MiB;
constexpr size_t WS_V = WS_R + 224 * MiB;
constexpr size_t WS_CAT = WS_R + 256 * MiB;
constexpr size_t WS_END = 512 * MiB;
constexpr size_t DOUT_WDT = 64 * MiB;
static_assert(WS_ACT + (size_t)NSLOT_H * 256 * 2 <= WS_END && WS_CAT + 64 * MiB <= WS_END, "ws map");

constexpr int CW_BAR = 4096;
constexpr int CW_CNT = 16384;

constexpr int RING_BYTES = 131072;
constexpr int LDSCTL_OFF = RING_BYTES, MISC_OFF = LDSCTL_OFF + 320;
constexpr int LDS_BYTES = 147456;

DEVI unsigned f2bf(float f) { unsigned u = __builtin_bit_cast(unsigned, f); return (u + 0x7fffu + ((u >> 16) & 1u)) >> 16; }
DEVI unsigned pk2(float lo, float hi) { return f2bf(lo) | (f2bf(hi) << 16); }
DEVI float bf2f(unsigned h) { return __builtin_bit_cast(float, h << 16); }
DEVI float bflo(unsigned w) { return __builtin_bit_cast(float, w << 16); }
DEVI float bfhi(unsigned w) { return __builtin_bit_cast(float, w & 0xffff0000u); }
DEVI int crow(int r, int hi) { return (r & 3) + 8 * (r >> 2) + 4 * hi; }
DEVI float wave_sum(float v) {
#pragma unroll
    for (int o = 1; o < 64; o <<= 1) v += __shfl_xor(v, o);
    return v;
}
#define LDS_WAIT() asm volatile("s_waitcnt lgkmcnt(0)" ::: "memory")

#define XB_TMO      128
#define XB_XCNT(j)  (256  + 64 * (j))
#define XB_XSUB(j)  (1280 + 64 * (j))
#define XB_XGEN(j)  (2304 + 64 * (j))
#define XB_TOP      3328
#define XB_TOPGEN   3392
#define XCD_BAR_WORDS 3456
#define XB_SPIN_CAP (1u << 22)
DEVI unsigned xb_ld(unsigned* p)              { return __hip_atomic_load(p, __ATOMIC_RELAXED, __HIP_MEMORY_SCOPE_AGENT); }
DEVI unsigned xb_add(unsigned* p, unsigned v) { return __hip_atomic_fetch_add(p, v, __ATOMIC_RELAXED, __HIP_MEMORY_SCOPE_AGENT); }
DEVI unsigned xb_xcc_id() { return (unsigned)__builtin_amdgcn_s_getreg((3 << 11) | 20) & 0xFu; }
#define XB_SPIN(cond, bar) do { unsigned _sp = 0; while (cond) { __builtin_amdgcn_s_sleep(1); \
    if ((++_sp & 255u) == 0u) { if (xb_ld(&(bar)[XB_TMO])) break; if (_sp > XB_SPIN_CAP) { atomicAdd(&(bar)[XB_TMO], 1u); break; } } } } while (0)
struct XcdBarrier { unsigned* bar; unsigned x; volatile LAS unsigned* st; };
DEVI XcdBarrier xcd_barrier_post(unsigned* bar, volatile LAS unsigned* st) {
    XcdBarrier b; b.bar = bar; b.x = xb_xcc_id(); b.st = st;
    if (threadIdx.x == 0) (void)xb_add(&bar[XB_XCNT(b.x)], 1u);
    return b;
}
DEVI void xcd_barrier_complete(unsigned* bar, unsigned x, unsigned& nloc, unsigned& nx) {
    const unsigned G = gridDim.x * gridDim.y * gridDim.z;
    unsigned sum, cnt, mine, sp = 0u;
    for (;;) {
        sum = 0u; cnt = 0u; mine = 0u;
#pragma unroll
        for (unsigned j = 0; j < 16; ++j) { const unsigned c = xb_ld(&bar[XB_XCNT(j)]); sum += c; cnt += (c > 0u) ? 1u : 0u; mine = (j == x) ? c : mine; }
        if (sum == G) break;
        __builtin_amdgcn_s_sleep(1);
        if ((++sp & 255u) == 0u) { if (xb_ld(&bar[XB_TMO])) break; if (sp > XB_SPIN_CAP) { atomicAdd(&bar[XB_TMO], 1u); break; } }
    }
    nloc = mine > 0u ? mine : 1u; nx = cnt > 0u ? cnt : 1u;
}
DEVI void xcd_barrier(const XcdBarrier& b) {
    asm volatile("s_waitcnt vmcnt(0)" ::: "memory");
    __syncthreads();
    if (threadIdx.x == 0) {
        unsigned* bar = b.bar;
        __builtin_amdgcn_s_waitcnt(0);
        unsigned nloc = b.st[0], nx = b.st[1];
        if (nloc == 0u) { xcd_barrier_complete(bar, b.x, nloc, nx); b.st[0] = nloc; b.st[1] = nx; }
        const unsigned old = xb_add(&bar[XB_XSUB(b.x)], 1u);
        const unsigned gen = old / nloc;
        if (old + 1u == (gen + 1u) * nloc) {
            __builtin_amdgcn_fence(__ATOMIC_RELEASE, "agent");
            asm volatile("s_waitcnt vmcnt(0)" ::: "memory");
            const unsigned og = xb_add(&bar[XB_TOP], 1u);
            const unsigned tg = og / nx;
            if (og + 1u == (tg + 1u) * nx) xb_add(&bar[XB_TOPGEN], 1u);
            else XB_SPIN(xb_ld(&bar[XB_TOPGEN]) == tg, bar);
            __builtin_amdgcn_fence(__ATOMIC_ACQUIRE, "agent");
            xb_add(&bar[XB_XGEN(b.x)], 1u);
            asm volatile("s_waitcnt vmcnt(0)" ::: "memory");
        } else {
            XB_SPIN(xb_ld(&bar[XB_XGEN(b.x)]) == gen, bar);
            __builtin_amdgcn_fence(__ATOMIC_ACQUIRE, "agent");
            asm volatile("s_waitcnt vmcnt(0)" ::: "memory");
        }
    }
    __syncthreads();
}

struct Frame {
    LAS unsigned char* lds;
    gu32* ctl;
    int tid, lane, wave, vcu, G, gw, NGW;
    const float* in[21]; float* out; unsigned char* ws;
};
#define IN_X 0
#define IN_WIN 1
#define IN_WPOOL 2
#define IN_PSCALE 3
#define IN_QG 4
#define IN_WQ 5
#define IN_KVG 6
#define IN_WKV 7
#define IN_WOUT 8
#define IN_LN1G 9
#define IN_LN1B 10
#define IN_WR 11
#define IN_RB 12
#define IN_WG 13
#define IN_WU 14
#define IN_WD 15
#define IN_SG 16
#define IN_SU 17
#define IN_SD 18
#define IN_LN2G 19
#define IN_LN2B 20

template <class RowMap>
DEVI void tr_item(const float* W, int ldw, const float* ksc, bf16* WT, int ldo, RowMap rm, LAS float* scr, int k0, int n0, int lane) {
#pragma unroll 8
    for (int i = 0; i < 32; ++i) { const int kk = 2 * i + (lane >> 5); float v = W[(size_t)(k0 + kk) * ldw + n0 + (lane & 31)]; if (ksc) v *= ksc[k0 + kk]; scr[kk * 33 + (lane & 31)] = v; }
    LDS_WAIT(); asm volatile("" ::: "memory");
    const int c = lane & 7;
#pragma unroll
    for (int j = 0; j < 4; ++j) { const int n = (lane >> 3) + 8 * j; const LAS float* s = scr + (8 * c) * 33 + n;
        u32x4 o; o.x = pk2(s[0 * 33], s[1 * 33]); o.y = pk2(s[2 * 33], s[3 * 33]); o.z = pk2(s[4 * 33], s[5 * 33]); o.w = pk2(s[6 * 33], s[7 * 33]);
        *(u32x4*)(WT + (size_t)rm(n0 + n) * ldo + k0 + 8 * c) = o; }
    LDS_WAIT(); asm volatile("" ::: "memory");
}
struct RmId { DEVI int operator()(int n) const { return n; } };
struct RmGU { int up; DEVI int operator()(int c) const { return 32 * (c >> 4) + (c & 15) + 16 * up; } };

DEVI void p0_prep(Frame& F) {
    LAS float* scr = (LAS float*)(F.lds + F.wave * 16384);
    const int gw = F.gw, NGW = F.NGW, lane = F.lane;
    bf16* WinT = (bf16*)(F.ws + WS_WIN); bf16* WqT = (bf16*)(F.ws + WS_WQ); bf16* WkvT = (bf16*)(F.ws + WS_WKV); bf16* WoT = (bf16*)(F.ws + WS_WO);
    bf16* W13T = (bf16*)(F.ws + WS_W13T);
    for (int it = gw; it < 16 * 29; it += NGW) tr_item(F.in[IN_WIN], 928, nullptr, WinT, 1024, RmId(), scr, 64 * (it / 29), 32 * (it % 29), lane);
    for (int i = F.vcu * 512 + F.tid; i < 12288; i += F.G * 512) *(u32x4*)((char*)(WinT + 928 * 1024) + (size_t)i * 16) = (u32x4){0u, 0u, 0u, 0u};
    for (int it = gw; it < 4 * 24; it += NGW) tr_item(F.in[IN_WQ], 768, F.in[IN_QG], WqT, 256, RmId(), scr, 64 * (it / 24), 32 * (it % 24), lane);
    for (int it = gw; it < 2 * 32; it += NGW) tr_item(F.in[IN_WKV], 1024, F.in[IN_KVG], WkvT, 128, RmId(), scr, 64 * (it / 32), 32 * (it % 32), lane);
    for (int it = gw; it < 8 * 32; it += NGW) tr_item(F.in[IN_WOUT] + 512 * 1024, 1024, nullptr, WoT + 512, 1024, RmId(), scr, 64 * (it / 32), 32 * (it % 32), lane);
    for (int it = gw; it < 4 * 16 * 16; it += NGW) {
        const int g = it >> 8, cb = (it >> 4) & 15, nb = it & 15, n = nb * 64 + lane;
        const float* wp = F.in[IN_WPOOL] + ((size_t)g * 128 + cb * 8) * 128; const float* ps = F.in[IN_PSCALE] + g * 128; const float* wo = F.in[IN_WOUT] + (size_t)g * 128 * 1024 + n;
        float a[8] = {0.f, 0.f, 0.f, 0.f, 0.f, 0.f, 0.f, 0.f};
        for (int d = 0; d < 128; ++d) { const float w = wo[(size_t)d * 1024] * ps[d];
#pragma unroll
            for (int c = 0; c < 8; ++c) a[c] += wp[c * 128 + d] * w; }
        u32x4 o; o.x = pk2(a[0], a[1]); o.y = pk2(a[2], a[3]); o.z = pk2(a[4], a[5]); o.w = pk2(a[6], a[7]);
        *(u32x4*)(WoT + (size_t)n * 1024 + g * 128 + cb * 8) = o;
    }
    for (int it = gw; it < 65 * 2 * 128; it += NGW) {
        const int e = it >> 8, up = (it >> 7) & 1, r = it & 127, kb = r >> 3, nb = r & 7;
        const float* W = (e < 64) ? (up ? F.in[IN_WU] : F.in[IN_WG]) + (size_t)e * 1024 * 256 : (up ? F.in[IN_SU] : F.in[IN_SG]);
        RmGU rm; rm.up = up;
        tr_item(W, 256, nullptr, W13T + (size_t)e * 512 * 1024, 1024, rm, scr, 64 * kb, 32 * nb, lane);
    }
    {
        float* cosT = (float*)(F.ws + WS_ROPE); float* sinT = cosT + 4096 * 16;
        for (int i = F.vcu * 512 + F.tid; i < 4096 * 16; i += F.G * 512) {
            const int pos = i >> 4, j = i & 15;
            const double invf = exp2(-(double)j * (13.287712379549449 / 16.0));
            const double ang = (double)pos * invf;
            const double TWO_PI = 6.283185307179586476925286766559;
            const double n = rint(ang / TWO_PI); const double r = ang - n * TWO_PI;
            cosT[i] = (float)cos(r); sinT[i] = (float)sin(r);
        }
    }
    { float* ssq = (float*)(F.ws + WS_SSQ); for (int i = F.vcu * 512 + F.tid; i < 2 * NTOK; i += F.G * 512) ssq[i] = 0.f; }
}
DEVI void p0_wdt(Frame& F) {
    LAS float* scr = (LAS float*)(F.lds + F.wave * 16384);
    bf16* WdT = (bf16*)((char*)F.out + DOUT_WDT);
    for (int it = F.gw; it < 65 * 128; it += F.NGW) {
        const int e = it >> 7, r = it & 127, kb = r >> 5, nb = r & 31;
        const float* W = (e < 64) ? F.in[IN_WD] + (size_t)e * 256 * 1024 : F.in[IN_SD];
        tr_item(W, 1024, nullptr, WdT + (size_t)e * 1024 * 256, 256, RmId(), scr, 64 * kb, 32 * nb, F.lane);
    }
}

DEVI bf16x8 ld8(const bf16* p) { return *(const bf16x8*)p; }
DEVI bf16x8 ld8(const float* p) { const f32x4 a = *(const f32x4*)p, b = *(const f32x4*)(p + 4);
    u32x4 w; w.x = pk2(a.x, a.y); w.y = pk2(a.z, a.w); w.z = pk2(b.x, b.y); w.w = pk2(b.z, b.w); return __builtin_bit_cast(bf16x8, w); }
template <class TA>
DEVI f32x16 wave_tile(const TA* arow, const bf16* brow, int K) {
    f32x16 acc = {};
#pragma unroll 4
    for (int k = 0; k < K; k += 16) acc = __builtin_amdgcn_mfma_f32_32x32x16_bf16(ld8(arow + k), ld8(brow + k), acc, 0, 0, 0);
    return acc;
}

DEVI void p1_simple(Frame& F) {
    const int lane = F.lane, r = lane & 31, hh = lane >> 5;
    bf16* proj = (bf16*)(F.ws + WS_PROJ); const bf16* WinT = (const bf16*)(F.ws + WS_WIN); bf16* Kb = (bf16*)(F.ws + WS_K);
    float* ssq_q = (float*)(F.ws + WS_SSQ); float* ssq_kv = ssq_q + NTOK;
    const float* cosT = (const float*)(F.ws + WS_ROPE); const float* sinT = cosT + 4096 * 16;
    for (int t = F.gw; t < 1024 * 29; t += F.NGW) {
        const int mt = t / 29, nt = t % 29, m0 = mt * 32, n0 = nt * 32;
        const f32x16 acc = wave_tile(F.in[IN_X] + (size_t)(m0 + r) * 1024 + 8 * hh, WinT + (size_t)(n0 + r) * 1024 + 8 * hh, 1024);
        if (n0 < 896) {
#pragma unroll
            for (int i = 0; i < 16; ++i) proj[(size_t)(m0 + crow(i, hh)) * 1024 + n0 + r] = (bf16)f2bf(acc[i]);
            if (n0 >= 512) {
                float* dst = (n0 < 768) ? ssq_q : ssq_kv;
#pragma unroll
                for (int i = 0; i < 16; ++i) { float s = acc[i] * acc[i]; s += __shfl_xor(s, 1); s += __shfl_xor(s, 2); s += __shfl_xor(s, 4); s += __shfl_xor(s, 8); s += __shfl_xor(s, 16);
                    if (r == 0) atomicAdd(dst + m0 + crow(i, hh), s); }
            }
        } else {
#pragma unroll
            for (int i = 0; i < 16; ++i) {
                const int row = m0 + crow(i, hh), pos = row & 4095, b = row >> 12;
                const float v = acc[i], p = __shfl_xor(v, 16);
                const float cs = cosT[pos * 16 + (r & 15)], sn = sinT[pos * 16 + (r & 15)];
                const float o = (r < 16) ? v * cs - p * sn : v * cs + p * sn;
                const bf16 ob = (bf16)f2bf(o);
#pragma unroll
                for (int h = 0; h < 8; ++h) Kb[((size_t)(b * 8 + h) * 4096 + pos) * 96 + 64 + r] = ob;
            }
        }
    }
}
DEVI void p2_simple(Frame& F) {
    const int lane = F.lane, r = lane & 31, hh = lane >> 5;
    const bf16* proj = (const bf16*)(F.ws + WS_PROJ); const bf16* WqT = (const bf16*)(F.ws + WS_WQ); const bf16* WkvT = (const bf16*)(F.ws + WS_WKV);
    bf16* Qb = (bf16*)(F.ws + WS_Q); bf16* Kb = (bf16*)(F.ws + WS_K); bf16* Vb = (bf16*)(F.ws + WS_V); bf16* cat = (bf16*)(F.ws + WS_CAT);
    const float* ssq_q = (const float*)(F.ws + WS_SSQ); const float* ssq_kv = ssq_q + NTOK;
    const float* cosT = (const float*)(F.ws + WS_ROPE); const float* sinT = cosT + 4096 * 16;
    for (int t = F.gw; t < 1024 * 24; t += F.NGW) {
        const int mt = t / 24, nt = t % 24, m0 = mt * 32, n0 = nt * 32, head = nt / 3, part = nt % 3;
        const f32x16 acc = wave_tile(proj + (size_t)(m0 + r) * 1024 + 512 + 8 * hh, WqT + (size_t)(n0 + r) * 256 + 8 * hh, 256);
#pragma unroll
        for (int i = 0; i < 16; ++i) {
            const int row = m0 + crow(i, hh), pos = row & 4095, b = row >> 12;
            float v = acc[i] * __builtin_amdgcn_rsqf(ssq_q[row] * (1.f / 256.f) + RMS_EPS);
            if (part == 2) { const float p = __shfl_xor(v, 16); const float cs = cosT[pos * 16 + (r & 15)], sn = sinT[pos * 16 + (r & 15)]; v = (r < 16) ? v * cs - p * sn : v * cs + p * sn; }
            Qb[((size_t)(b * 8 + head) * 4096 + pos) * 96 + part * 32 + r] = (bf16)f2bf(v * C2);
        }
    }
    for (int t = F.gw; t < 1024 * 32; t += F.NGW) {
        const int mt = t >> 5, nt = t & 31, m0 = mt * 32, n0 = nt * 32, head = nt >> 2, cc = (n0 & 127) + r;
        const f32x16 acc = wave_tile(proj + (size_t)(m0 + r) * 1024 + 768 + 8 * hh, WkvT + (size_t)(n0 + r) * 128 + 8 * hh, 128);
#pragma unroll
        for (int i = 0; i < 16; ++i) {
            const int row = m0 + crow(i, hh), pos = row & 4095, b = row >> 12;
            const float v = acc[i] * __builtin_amdgcn_rsqf(ssq_kv[row] * (1.f / 128.f) + RMS_EPS);
            const size_t tk = (size_t)(b * 8 + head) * 4096 + pos;
            if (cc < 64) Kb[tk * 96 + cc] = (bf16)f2bf(v); else Vb[tk * 64 + cc - 64] = (bf16)f2bf(v);
        }
    }
    for (int i = F.vcu * 512 + F.tid; i < NTOK * 64; i += F.G * 512) {
        const int tkn = i >> 6, c8 = (i & 63) * 8, g = c8 >> 7, w = 2 << g, left = w >> 1, right = w - 1 - left;
        const int pos = tkn & 4095, base = tkn - pos;
        const int lo = max(pos - left, 0), hi = min(pos + right + 1, SEQ);
        float s[8] = {0.f, 0.f, 0.f, 0.f, 0.f, 0.f, 0.f, 0.f};
        for (int p = lo; p < hi; ++p) { const u32x4 u = *(const u32x4*)(proj + (size_t)(base + p) * 1024 + c8);
            s[0] += bflo(u.x); s[1] += bfhi(u.x); s[2] += bflo(u.y); s[3] += bfhi(u.y); s[4] += bflo(u.z); s[5] += bfhi(u.z); s[6] += bflo(u.w); s[7] += bfhi(u.w); }
        const float inv = 1.f / (float)(hi - lo);
        const u32x4 u = *(const u32x4*)(proj + (size_t)tkn * 1024 + c8);
        u32x4 o; o.x = pk2(s[0] * inv - bflo(u.x), s[1] * inv - bfhi(u.x)); o.y = pk2(s[2] * inv - bflo(u.y), s[3] * inv - bfhi(u.y));
        o.z = pk2(s[4] * inv - bflo(u.z), s[5] * inv - bfhi(u.z)); o.w = pk2(s[6] * inv - bflo(u.w), s[7] * inv - bfhi(u.w));
        *(u32x4*)(cat + (size_t)tkn * 1024 + c8) = o;
    }
}
DEVI void p3_simple(Frame& F) {
    const int lane = F.lane, r = lane & 31, hh = lane >> 5;
    const bf16* Qb = (const bf16*)(F.ws + WS_Q); const bf16* Kb = (const bf16*)(F.ws + WS_K); const bf16* Vb = (const bf16*)(F.ws + WS_V); bf16* cat = (bf16*)(F.ws + WS_CAT);
    for (int it = F.gw; it < 64 * 128; it += F.NGW) {
        const int bh = it >> 7, q0 = (it & 127) * 32;
        const bf16* Qp = Qb + ((size_t)bh * 4096 + q0 + r) * 96 + 8 * hh;
        bf16x8 qf[6];
#pragma unroll
        for (int d0 = 0; d0 < 6; ++d0) qf[d0] = ld8(Qp + 16 * d0);
        float m = -1e30f, lsum = 0.f; f32x16 o0 = {}, o1 = {};
        const bf16* Kh = Kb + (size_t)bh * 4096 * 96; const bf16* Vh = Vb + (size_t)bh * 4096 * 64;
        for (int k0 = 0; k0 < SEQ; k0 += 32) {
            f32x16 p = {};
            const bf16* kp = Kh + (size_t)(k0 + r) * 96 + 8 * hh;
#pragma unroll
            for (int d0 = 0; d0 < 6; ++d0) p = __builtin_amdgcn_mfma_f32_32x32x16_bf16(ld8(kp + 16 * d0), qf[d0], p, 0, 0, 0);
            float mx = p[0];
#pragma unroll
            for (int i = 1; i < 16; ++i) mx = fmaxf(mx, p[i]);
            mx = fmaxf(mx, __shfl_xor(mx, 32));
            const float mn = fmaxf(m, mx), alpha = __builtin_amdgcn_exp2f(m - mn); m = mn;
            float rs = 0.f;
#pragma unroll
            for (int i = 0; i < 16; ++i) { p[i] = __builtin_amdgcn_exp2f(p[i] - mn); rs += p[i]; }
            rs += __shfl_xor(rs, 32); lsum = lsum * alpha + rs;
#pragma unroll
            for (int i = 0; i < 16; ++i) { o0[i] *= alpha; o1[i] *= alpha; }
#pragma unroll
            for (int s = 0; s < 2; ++s) {
                u32x4 pw; pw.x = pk2(p[8 * s + 0], p[8 * s + 1]); pw.y = pk2(p[8 * s + 2], p[8 * s + 3]); pw.z = pk2(p[8 * s + 4], p[8 * s + 5]); pw.w = pk2(p[8 * s + 6], p[8 * s + 7]);
                const bf16x8 pb = __builtin_bit_cast(bf16x8, pw);
                bf16x8 va0, va1;
#pragma unroll
                for (int j = 0; j < 8; ++j) { const int key = k0 + 16 * s + 8 * (j >> 2) + 4 * hh + (j & 3); va0[j] = (short)Vh[(size_t)key * 64 + r]; va1[j] = (short)Vh[(size_t)key * 64 + 32 + r]; }
                o0 = __builtin_amdgcn_mfma_f32_32x32x16_bf16(va0, pb, o0, 0, 0, 0);
                o1 = __builtin_amdgcn_mfma_f32_32x32x16_bf16(va1, pb, o1, 0, 0, 0);
            }
        }
        const float inv = 1.f / lsum; const int b = bh >> 3, h = bh & 7;
        bf16* op = cat + ((size_t)b * 4096 + q0 + r) * 1024 + 512 + h * 64;
#pragma unroll
        for (int i = 0; i < 16; ++i) { op[crow(i, hh)] = (bf16)f2bf(o0[i] * inv); op[32 + crow(i, hh)] = (bf16)f2bf(o1[i] * inv); }
    }
}
DEVI void p4_simple(Frame& F) {
    const int lane = F.lane, r = lane & 31, hh = lane >> 5;
    const bf16* cat = (const bf16*)(F.ws + WS_CAT); const bf16* WoT = (const bf16*)(F.ws + WS_WO);
    for (int t = F.gw; t < 1024 * 32; t += F.NGW) {
        const int mt = t >> 5, nt = t & 31, m0 = mt * 32, n0 = nt * 32;
        const f32x16 acc = wave_tile(cat + (size_t)(m0 + r) * 1024 + 8 * hh, WoT + (size_t)(n0 + r) * 1024 + 8 * hh, 1024);
#pragma unroll
        for (int i = 0; i < 16; ++i) { const size_t o = (size_t)(m0 + crow(i, hh)) * 1024 + n0 + r; F.out[o] = ALPHA * F.in[IN_X][o] + acc[i]; }
    }
}
template <bool DO_LN>
DEVI void p5_rows(Frame& F) {
    const int lane = F.lane;
    bf16* h1b = (bf16*)(F.ws + WS_H1B); int* tokslot = (int*)(F.ws + WS_TOKSLOT); float* tokw = (float*)(F.ws + WS_TOKW); int* list = (int*)(F.ws + WS_LIST);
    const float* wr = F.in[IN_WR]; const float bias = F.in[IN_RB][lane];
    for (int it = F.gw; it < NTOK / 4; it += F.NGW) {
        const int t0 = it * 4;
        f32x4 v[4][4];
#pragma unroll
        for (int rr = 0; rr < 4; ++rr)
#pragma unroll
            for (int j = 0; j < 4; ++j) v[rr][j] = *(const f32x4*)(F.out + (size_t)(t0 + rr) * 1024 + 256 * j + 4 * lane);
        if (DO_LN) {
            f32x4 g[4], bb[4];
#pragma unroll
            for (int j = 0; j < 4; ++j) { g[j] = *(const f32x4*)(F.in[IN_LN1G] + 256 * j + 4 * lane); bb[j] = *(const f32x4*)(F.in[IN_LN1B] + 256 * j + 4 * lane); }
#pragma unroll
            for (int rr = 0; rr < 4; ++rr) {
                float s = 0.f;
#pragma unroll
                for (int j = 0; j < 4; ++j) s += (v[rr][j].x + v[rr][j].y) + (v[rr][j].z + v[rr][j].w);
                const float mean = wave_sum(s) * (1.f / 1024.f); float s2 = 0.f;
#pragma unroll
                for (int j = 0; j < 4; ++j) { v[rr][j] = v[rr][j] - mean; s2 += (v[rr][j].x * v[rr][j].x + v[rr][j].y * v[rr][j].y) + (v[rr][j].z * v[rr][j].z + v[rr][j].w * v[rr][j].w); }
                const float rstd = __builtin_amdgcn_rsqf(wave_sum(s2) * (1.f / 1024.f) + LN_EPS);
#pragma unroll
                for (int j = 0; j < 4; ++j) v[rr][j] = v[rr][j] * rstd * g[j] + bb[j];
            }
        }
#pragma unroll
        for (int rr = 0; rr < 4; ++rr)
#pragma unroll
            for (int j = 0; j < 4; ++j) { u32x2 o; o.x = pk2(v[rr][j].x, v[rr][j].y); o.y = pk2(v[rr][j].z, v[rr][j].w); *(u32x2*)(h1b + (size_t)(t0 + rr) * 1024 + 256 * j + 4 * lane) = o; }
        float acc[4] = {0.f, 0.f, 0.f, 0.f};
        asm volatile("s_waitcnt vmcnt(0)" ::: "memory");
        for (int k = 0; k < 1024; ++k) {
            const float w = wr[(size_t)k * 64 + lane];
#pragma unroll
            for (int rr = 0; rr < 4; ++rr) acc[rr] += bf2f(h1b[(size_t)(t0 + rr) * 1024 + k]) * w;
        }
#pragma unroll
        for (int rr = 0; rr < 4; ++rr) {
            const int tkn = t0 + rr;
            const float s = 1.f / (1.f + __expf(-acc[rr])); const float b = s + bias;
            int rank8 = 0;
#pragma unroll
            for (int d = 1; d < 8; ++d) { const float o = __shfl_xor(b, d); const int pe = lane ^ d; rank8 += ((o > b) || (o == b && pe < lane)) ? 1 : 0; }
            float gs = rank8 < 2 ? b : 0.f; gs += __shfl_xor(gs, 1); gs += __shfl_xor(gs, 2); gs += __shfl_xor(gs, 4);
            const int g = lane >> 3; int grank = 0;
#pragma unroll
            for (int dg = 1; dg < 8; ++dg) { const float og = __shfl_xor(gs, dg * 8); const int pg = g ^ dg; grank += ((og > gs) || (og == gs && pg < g)) ? 1 : 0; }
            const float mb = grank < 4 ? b : -INFINITY;
            int rank = 0;
            for (int j = 0; j < 64; ++j) { const float vj = __builtin_bit_cast(float, __builtin_amdgcn_readlane(__builtin_bit_cast(int, mb), j)); rank += ((vj > mb) || (vj == mb && j < lane)) ? 1 : 0; }
            const bool sel = rank < 8;
            const float tot = wave_sum(sel ? s : 0.f);
            if (sel) {
                const int hf = tkn >> 14;
                const unsigned pos = __hip_atomic_fetch_add((unsigned*)F.ctl + CW_CNT + (hf * 64 + lane) * 64, 1u, RLX_AGENT);
                list[((size_t)(hf * 64 + lane)) * 16384 + pos] = tkn;
                tokslot[tkn * 8 + rank] = (lane << 16) | (int)pos;
                tokw[tkn * 8 + rank] = s / tot * 2.5f;
            }
        }
    }
}
struct ExpScan { int cnt, incl; };
DEVI ExpScan exp_scan(Frame& F, int hf) {
    ExpScan s; s.cnt = (int)__hip_atomic_load((unsigned*)F.ctl + CW_CNT + (hf * 64 + F.lane) * 64, RLX_AGENT);
    int x = s.cnt;
#pragma unroll
    for (int o = 1; o < 64; o <<= 1) { const int y = __shfl_up(x, o); if (F.lane >= o) x += y; }
    s.incl = x; return s;
}
DEVI void p6_simple(Frame& F, int hf) {
    const int lane = F.lane, r = lane & 31, hh = lane >> 5;
    const bf16* h1b = (const bf16*)(F.ws + WS_H1B); const bf16* W13T = (const bf16*)(F.ws + WS_W13T); bf16* act = (bf16*)(F.ws + WS_ACT);
    const int* list = (const int*)(F.ws + WS_LIST) + (size_t)hf * 64 * 16384;
    const ExpScan es = exp_scan(F, hf);
    int tl = ((es.cnt + 31) >> 5) * 8, ti = tl;
#pragma unroll
    for (int o = 1; o < 64; o <<= 1) { const int y = __shfl_up(ti, o); if (lane >= o) ti += y; }
    const int tot_routed = __shfl(ti, 63), tot = tot_routed + (HALF_T / 32) * 8;
    for (int t = F.gw; t < tot; t += F.NGW) {
        int e, lt, cnt, start;
        if (t < tot_routed) { e = __popcll(__ballot(ti <= t)); const int base = e ? __shfl(ti, e - 1) : 0; lt = t - base; cnt = __shfl(es.cnt, e); start = __shfl(es.incl, e) - cnt; }
        else { e = 64; lt = t - tot_routed; cnt = HALF_T; start = HALF_T * 8; }
        const int mt = lt >> 3, n0 = (lt & 7) * 32, i0 = mt * 32 + r;
        int tok;
        if (e < 64) tok = list[(size_t)e * 16384 + min(i0, cnt - 1)]; else tok = hf * HALF_T + i0;
        const bf16* arow = h1b + (size_t)tok * 1024 + 8 * hh;
        const int c = n0 + r, nrow = 32 * (c >> 4) + (c & 15);
        const bf16* bg = W13T + ((size_t)e * 512 + nrow) * 1024 + 8 * hh; const bf16* bu = bg + 16 * 1024;
        f32x16 ag = {}, au = {};
#pragma unroll 2
        for (int k = 0; k < 1024; k += 16) { const bf16x8 a = ld8(arow + k); ag = __builtin_amdgcn_mfma_f32_32x32x16_bf16(a, ld8(bg + k), ag, 0, 0, 0); au = __builtin_amdgcn_mfma_f32_32x32x16_bf16(a, ld8(bu + k), au, 0, 0, 0); }
#pragma unroll
        for (int i = 0; i < 16; ++i) { const int ii = mt * 32 + crow(i, hh);
            if (ii < cnt) { const float gte = ag[i]; const float sv = gte / (1.f + __expf(-gte)); act[(size_t)(start + ii) * 256 + c] = (bf16)f2bf(sv * au[i]); } }
    }
}
DEVI void p7_simple(Frame& F, int hf) {
    const int lane = F.lane, r = lane & 31, hh = lane >> 5;
    const bf16* act = (const bf16*)(F.ws + WS_ACT); const bf16* WdT = (const bf16*)((const char*)F.out + DOUT_WDT); bf16* so = (bf16*)(F.ws + WS_SLOT);
    const ExpScan es = exp_scan(F, hf);
    int tl = ((es.cnt + 31) >> 5) * 32, ti = tl;
#pragma unroll
    for (int o = 1; o < 64; o <<= 1) { const int y = __shfl_up(ti, o); if (lane >= o) ti += y; }
    const int tot_routed = __shfl(ti, 63), tot = tot_routed + (HALF_T / 32) * 32;
    for (int t = F.gw; t < tot; t += F.NGW) {
        int e, lt, cnt, start;
        if (t < tot_routed) { e = __popcll(__ballot(ti <= t)); const int base = e ? __shfl(ti, e - 1) : 0; lt = t - base; cnt = __shfl(es.cnt, e); start = __shfl(es.incl, e) - cnt; }
        else { e = 64; lt = t - tot_routed; cnt = HALF_T; start = HALF_T * 8; }
        const int mt = lt >> 5, n0 = (lt & 31) * 32, i0 = min(mt * 32 + r, cnt - 1);
        const f32x16 acc = wave_tile(act + (size_t)(start + i0) * 256 + 8 * hh, WdT + ((size_t)e * 1024 + n0 + r) * 256 + 8 * hh, 256);
#pragma unroll
        for (int i = 0; i < 16; ++i) { const int ii = mt * 32 + crow(i, hh); if (ii < cnt) so[(size_t)(start + ii) * 1024 + n0 + r] = (bf16)f2bf(acc[i]); }
    }
}
DEVI void p8_simple(Frame& F, int hf) {
    const int lane = F.lane;
    const bf16* h1b = (const bf16*)(F.ws + WS_H1B); const bf16* so = (const bf16*)(F.ws + WS_SLOT);
    const int* tokslot = (const int*)(F.ws + WS_TOKSLOT); const float* tokw = (const float*)(F.ws + WS_TOKW);
    const ExpScan es = exp_scan(F, hf);
    const int startv = es.incl - es.cnt;
    f32x4 g[4], bb[4];
#pragma unroll
    for (int j = 0; j < 4; ++j) { g[j] = *(const f32x4*)(F.in[IN_LN2G] + 256 * j + 4 * lane); bb[j] = *(const f32x4*)(F.in[IN_LN2B] + 256 * j + 4 * lane); }
    for (int it = F.gw; it < HALF_T; it += F.NGW) {
        const int tkn = hf * HALF_T + it;
        f32x4 v[4];
#pragma unroll
        for (int j = 0; j < 4; ++j) { const u32x2 u = *(const u32x2*)(h1b + (size_t)tkn * 1024 + 256 * j + 4 * lane); v[j] = (f32x4){bflo(u.x), bfhi(u.x), bflo(u.y), bfhi(u.y)} * ALPHA; }
        const int myslot = (lane < 8) ? tokslot[tkn * 8 + lane] : 0; const float myw = (lane < 8) ? tokw[tkn * 8 + lane] : 0.f;
#pragma unroll
        for (int k = 0; k < 9; ++k) {
            int slot; float w;
            if (k < 8) { const int ts = __shfl(myslot, k); const int e = ts >> 16, pos = ts & 0xffff; slot = __shfl(startv, e) + pos; w = __shfl(myw, k); }
            else { slot = HALF_T * 8 + it; w = 1.f; }
#pragma unroll
            for (int j = 0; j < 4; ++j) { const u32x2 u = *(const u32x2*)(so + (size_t)slot * 1024 + 256 * j + 4 * lane); v[j] = v[j] + (f32x4){bflo(u.x), bfhi(u.x), bflo(u.y), bfhi(u.y)} * w; }
        }
        float s = 0.f;
#pragma unroll
        for (int j = 0; j < 4; ++j) s += (v[j].x + v[j].y) + (v[j].z + v[j].w);
        const float mean = wave_sum(s) * (1.f / 1024.f); float s2 = 0.f;
#pragma unroll
        for (int j = 0; j < 4; ++j) { v[j] = v[j] - mean; s2 += (v[j].x * v[j].x + v[j].y * v[j].y) + (v[j].z * v[j].z + v[j].w * v[j].w); }
        const float rstd = __builtin_amdgcn_rsqf(wave_sum(s2) * (1.f / 1024.f) + LN_EPS);
#pragma unroll
        for (int j = 0; j < 4; ++j) *(f32x4*)(F.out + (size_t)tkn * 1024 + 256 * j + 4 * lane) = v[j] * rstd * g[j] + bb[j];
    }
}

struct Args { const float* in[21]; float* out; unsigned char* ws; int ph_lo, ph_hi; };
constexpr int NPHASE = 12;
__global__ void __launch_bounds__(512, 2) mk_fwd(Args args) {
    extern __shared__ __attribute__((aligned(16))) unsigned char lds[];
    Frame F;
    F.lds = (LAS unsigned char*)lds;
    F.tid = threadIdx.x; F.lane = F.tid & 63; F.wave = __builtin_amdgcn_readfirstlane(F.tid >> 6);
    F.G = gridDim.x; { const int bx = blockIdx.x; F.vcu = (F.G % 8 == 0) ? (bx % 8) * (F.G / 8) + bx / 8 : bx; }
    F.gw = F.vcu * 8 + F.wave; F.NGW = F.G * 8;
    F.ws = args.ws; F.out = args.out; F.ctl = (gu32*)(args.ws + WS_CTL);
#pragma unroll
    for (int i = 0; i < 21; ++i) F.in[i] = args.in[i];
    for (int u = F.tid; u < (LDS_BYTES - LDSCTL_OFF) / 4; u += 512) ((LAS unsigned*)(F.lds + LDSCTL_OFF))[u] = 0u;
    __syncthreads();
    const int lo = args.ph_lo, hi = args.ph_hi;
    XcdBarrier bar; bar.bar = (unsigned*)(F.ctl + CW_BAR); bar.x = 0; bar.st = nullptr;
    if (hi - lo > 1) bar = xcd_barrier_post((unsigned*)(F.ctl + CW_BAR), (volatile LAS unsigned*)(F.lds + MISC_OFF) + 8);
#define IN(k) (lo <= (k) && (k) < hi)
#define SEAM(k) do { if (IN(k) && IN((k) + 1)) xcd_barrier(bar); } while (0)
    if (IN(0)) { p0_prep(F); } SEAM(0);
    if (IN(1)) { p1_simple(F); } SEAM(1);
    if (IN(2)) { p2_simple(F); } SEAM(2);
    if (IN(3)) { p3_simple(F); } SEAM(3);
    if (IN(4)) { p4_simple(F); } SEAM(4);
    if (IN(5)) { p5_rows<true>(F); } SEAM(5);
    if (IN(6)) { p0_wdt(F); p6_simple(F, 0); } SEAM(6);
    if (IN(7)) { p7_simple(F, 0); } SEAM(7);
    if (IN(8)) { p8_simple(F, 0); } SEAM(8);
    if (IN(9)) { p6_simple(F, 1); } SEAM(9);
    if (IN(10)) { p7_simple(F, 1); } SEAM(10);
    if (IN(11)) { p8_simple(F, 1); }
#undef IN
#undef SEAM
}

#ifndef MK_PER_PHASE
#define MK_PER_PHASE 0
#endif
extern "C" void kernel_launch(void* const* d_in, const int* in_sizes, int n_in, void* d_out, int out_size, void* d_ws, size_t ws_size, hipStream_t stream) {
    static int grid = 0;
    if (grid == 0) {
        if (n_in != 21 || in_sizes[0] != NTOK * DM || out_size != NTOK * DM || ws_size < WS_END) {
            fprintf(stderr, "kernel_launch: unexpected shapes: n_in %d in0 %d out %d ws %zu (need %zu)\n", n_in, n_in > 0 ? in_sizes[0] : -1, out_size, ws_size, (size_t)WS_END); grid = -1; return; }
        int dev = 0, cus = 0;
        if (hipGetDevice(&dev) != hipSuccess || hipDeviceGetAttribute(&cus, hipDeviceAttributeMultiprocessorCount, dev) != hipSuccess) { grid = -1; return; }
        if (hipFuncSetAttribute((const void*)mk_fwd, hipFuncAttributeMaxDynamicSharedMemorySize, LDS_BYTES) != hipSuccess) { fprintf(stderr, "kernel_launch: hipFuncSetAttribute failed\n"); grid = -1; return; }
        int per_cu = 0;
        if (hipOccupancyMaxActiveBlocksPerMultiprocessor(&per_cu, (const void*)mk_fwd, 512, LDS_BYTES) != hipSuccess || per_cu < 1) fprintf(stderr, "kernel_launch: occupancy query says %d\n", per_cu);
        (void)hipGetLastError();
        grid = cus;
    }
    if (grid < 0) return;
    (void)hipMemsetAsync((char*)d_ws + WS_CTL, 0, CTL_ZERO_BYTES, stream);
    Args a{};
    for (int i = 0; i < 21; ++i) a.in[i] = (const float*)d_in[i];
    a.out = (float*)d_out; a.ws = (unsigned char*)d_ws;
#if MK_PER_PHASE
    for (int p = 0; p < NPHASE; ++p) { a.ph_lo = p; a.ph_hi = p + 1; hipLaunchKernelGGL(mk_fwd, dim3(grid), dim3(512), LDS_BYTES, stream, a); }
#else
    a.ph_lo = 0; a.ph_hi = NPHASE;
    hipLaunchKernelGGL(mk_fwd, dim3(grid), dim3(512), LDS_BYTES, stream, a);
#endif
    const hipError_t le = hipPeekAtLastError();
    if (le != hipSuccess) fprintf(stderr, "kernel_launch: launch failed: %s\n", hipGetErrorName(le));
}
```
